# Optimizing an MI355X kernel written in HIP

```python
import math
import jax, jax.numpy as jnp
from jax import lax
import numpy as np

D_MODEL = 1024
BATCH = 4
SEQ = 4096
DEPTH = 2

CHUNK = 64
N_MIXERS = 2
N_RWKV = (DEPTH + 1) // 2
N_SSM = DEPTH // 2
RWKV_HEAD = 64
RWKV_HEADS = D_MODEL // RWKV_HEAD
DECAY_LORA = 64
AAA_LORA = 64
GATE_LORA = 160
GN_EPS = 64e-5
SSM_GROUP = 16
SSM_GROUPS = D_MODEL // SSM_GROUP
SSM_STATE = 64
D_FF = 4 * D_MODEL
DN_ALPHA = (2.0 * DEPTH) ** 0.25
DN_BETA = (8.0 * DEPTH) ** -0.25
LN_EPS = 1e-5

kernel_name = "rwkv7_s5_interleaved_deepnorm_trunk"


def layer_norm(x, g, b):
    xf = x.astype(jnp.float32)
    mu = jnp.mean(xf, axis=-1, keepdims=True)
    var = jnp.mean(jnp.square(xf - mu), axis=-1, keepdims=True)
    return ((xf - mu) * lax.rsqrt(var + LN_EPS) * g + b).astype(x.dtype)


def cmul(ar, ai, br, bi):
    return ar * br - ai * bi, ar * bi + ai * br


def rwkv7_time_mix(x, mu, w0, w1, w2, a0, a1, a2, g1, g2, k_k, k_a, r_k,
                   wr, wk, wv, wo, lnx_g, lnx_b):
    bsz, seq, d = x.shape
    f32 = jnp.float32
    xx = jnp.pad(x, ((0, 0), (1, 0), (0, 0)))[:, :-1] - x
    xr = x + xx * mu[0]
    xw = x + xx * mu[1]
    xk = x + xx * mu[2]
    xv = x + xx * mu[3]
    xa = x + xx * mu[4]
    xg = x + xx * mu[5]
    r = xr @ wr
    w_pre = (w0 + jnp.tanh(xw @ w1) @ w2).astype(f32)
    decay = jnp.exp(-jnp.exp(-jax.nn.softplus(-w_pre) - 0.5))
    k = xk @ wk
    v = xv @ wv
    a = jax.nn.sigmoid(a0 + (xa @ a1) @ a2)
    g = jax.nn.sigmoid(xg @ g1) @ g2

    def heads(t):
        return t.astype(f32).reshape(bsz, seq, RWKV_HEADS, RWKV_HEAD)

    kk = heads(k * k_k)
    kk = kk / jnp.maximum(jnp.sqrt(jnp.sum(kk * kk, axis=-1, keepdims=True)), 1e-12)
    k = k * (1.0 + (a - 1.0) * k_a)
    rh, kh, vh, ah, wh = heads(r), heads(k), heads(v), heads(a), heads(decay)
    seq_in = tuple(jnp.moveaxis(t, 1, 0) for t in (rh, wh, kh, vh, -kk, kk * ah))

    def step(state, inp):
        r_t, w_t, k_t, v_t, a_t, b_t = inp
        sa = jnp.einsum('bhvk,bhk->bhv', state, a_t)
        state = (state * w_t[:, :, None, :] + sa[..., None] * b_t[:, :, None, :]
                 + v_t[..., None] * k_t[:, :, None, :])
        return state, jnp.einsum('bhvk,bhk->bhv', state, r_t)

    s0 = jnp.zeros((bsz, RWKV_HEADS, RWKV_HEAD, RWKV_HEAD), f32)
    _, o = lax.scan(step, s0, seq_in)
    o = jnp.moveaxis(o, 0, 1)
    om = jnp.mean(o, axis=-1, keepdims=True)
    ov = jnp.mean(jnp.square(o - om), axis=-1, keepdims=True)
    o = ((o - om) * lax.rsqrt(ov + GN_EPS)).reshape(bsz, seq, d) * lnx_g + lnx_b
    bonus = jnp.sum(rh * kh * r_k.astype(f32), axis=-1, keepdims=True) * vh
    o = o + bonus.reshape(bsz, seq, d)
    return (o.astype(x.dtype) * g) @ wo


def s5_mix(x, a_re, a_im, log_dt, b_re, b_im, c_re, c_im, d_skip, w_glu):
    bsz, seq, d = x.shape
    f32 = jnp.float32
    xf = x.astype(f32)
    dt = jnp.exp(log_dt.astype(f32))[:, None]
    lam_re = jnp.minimum(a_re.astype(f32), -1e-4)
    lam_im = a_im.astype(f32)
    mag = jnp.exp(dt * lam_re)
    abar_re = mag * jnp.cos(dt * lam_im)
    abar_im = mag * jnp.sin(dt * lam_im)
    den = lam_re * lam_re + lam_im * lam_im
    nr, ni = abar_re - 1.0, abar_im
    coef_re = (nr * lam_re + ni * lam_im) / den
    coef_im = (ni * lam_re - nr * lam_im) / den
    bbar_re, bbar_im = cmul(coef_re[..., None], coef_im[..., None],
                            b_re.astype(f32), b_im.astype(f32))
    cr_w, ci_w = c_re.astype(f32), c_im.astype(f32)

    n_chunks = seq // CHUNK
    u = xf.reshape(bsz, n_chunks, CHUNK, SSM_GROUPS, SSM_GROUP).transpose(1, 2, 0, 3, 4)
    a_ch_re = jnp.broadcast_to(abar_re, (CHUNK, 1, SSM_GROUPS, SSM_STATE))
    a_ch_im = jnp.broadcast_to(abar_im, (CHUNK, 1, SSM_GROUPS, SSM_STATE))

    def combine(e1, e2):
        a1r, a1i, b1r, b1i = e1
        a2r, a2i, b2r, b2i = e2
        ar, ai = cmul(a2r, a2i, a1r, a1i)
        br, bi = cmul(a2r, a2i, b1r, b1i)
        return ar, ai, br + b2r, bi + b2i

    def chunk_step(h, u_c):
        h_re, h_im = h
        bu_re = jnp.einsum('tbgc,gpc->tbgp', u_c, bbar_re)
        bu_im = jnp.einsum('tbgc,gpc->tbgp', u_c, bbar_im)
        pr, pi, sr, si = lax.associative_scan(combine, (a_ch_re, a_ch_im, bu_re, bu_im), axis=0)
        carry_re, carry_im = cmul(pr, pi, h_re[None], h_im[None])
        s_re = sr + carry_re
        s_im = si + carry_im
        y = (jnp.einsum('tbgp,gcp->tbgc', s_re, cr_w)
             - jnp.einsum('tbgp,gcp->tbgc', s_im, ci_w))
        return (s_re[-1], s_im[-1]), y

    h0 = jnp.zeros((bsz, SSM_GROUPS, SSM_STATE), f32)
    _, y = lax.scan(chunk_step, (h0, h0), u)
    y = y.transpose(2, 0, 1, 3, 4).reshape(bsz, seq, d) + xf * d_skip.astype(f32)
    y = jax.nn.gelu(y).astype(x.dtype)
    z = y @ w_glu
    return z[..., :d] * jax.nn.sigmoid(z[..., d:])


def sq_relu_mlp(x, w1, w2):
    return jnp.square(jax.nn.relu(x @ w1)) @ w2


def setup_inputs(seed: int = 0) -> dict:
    key = jax.random.key(seed)
    ks = list(jax.random.split(key, 40))
    f32 = jnp.float32

    def nrm(i, shape, scale):
        return scale * jax.random.normal(ks[i], shape, f32)

    def uni(i, shape, lo, hi):
        return jax.random.uniform(ks[i], shape, f32, lo, hi)

    C, H, N = D_MODEL, RWKV_HEADS, RWKV_HEAD
    G, P, S = SSM_GROUPS, SSM_STATE, SSM_GROUP
    nr_, ns_ = N_RWKV, N_SSM
    glu = nrm(30, (ns_, C, 2 * C), C ** -0.5)
    glu = glu * jnp.concatenate([jnp.full((C,), DN_BETA, f32), jnp.ones((C,), f32)])
    a_im = jnp.pi * jnp.arange(P, dtype=f32)[None, None, :] + nrm(22, (ns_, G, P), 0.01)
    return {
        "x": nrm(0, (BATCH, SEQ, C), 1.0),
        "ln_g": 1.0 + nrm(1, (2 * DEPTH, C), 0.02),
        "ln_b": nrm(2, (2 * DEPTH, C), 0.02),
        "rw_mu": uni(3, (nr_, 6, C), 0.0, 1.0),
        "rw_w0": uni(4, (nr_, C), -6.0, -1.0),
        "rw_w1": nrm(5, (nr_, C, DECAY_LORA), C ** -0.5),
        "rw_w2": nrm(6, (nr_, DECAY_LORA, C), 0.1 * DECAY_LORA ** -0.5),
        "rw_a0": nrm(7, (nr_, C), 0.1),
        "rw_a1": nrm(8, (nr_, C, AAA_LORA), C ** -0.5),
        "rw_a2": nrm(9, (nr_, AAA_LORA, C), 0.1 * AAA_LORA ** -0.5),
        "rw_g1": nrm(10, (nr_, C, GATE_LORA), C ** -0.5),
        "rw_g2": nrm(11, (nr_, GATE_LORA, C), GATE_LORA ** -0.5),
        "rw_k_k": 0.85 + nrm(12, (nr_, C), 0.02),
        "rw_k_a": 1.0 + nrm(13, (nr_, C), 0.02),
        "rw_r_k": -0.04 + nrm(14, (nr_, H, N), 0.02),
        "rw_wr": nrm(15, (nr_, C, C), C ** -0.5),
        "rw_wk": nrm(16, (nr_, C, C), C ** -0.5),
        "rw_wv": nrm(17, (nr_, C, C), C ** -0.5),
        "rw_wo": nrm(18, (nr_, C, C), DN_BETA * C ** -0.5),
        "rw_lnx_g": 1.0 + nrm(19, (nr_, C), 0.02),
        "rw_lnx_b": nrm(20, (nr_, C), 0.02),
        "s5_a_re": -0.5 + nrm(21, (ns_, G, P), 0.01),
        "s5_a_im": a_im,
        "s5_log_dt": uni(23, (ns_, G), math.log(1e-3), math.log(1e-1)),
        "s5_b_re": nrm(24, (ns_, G, P, S), (2.0 * S) ** -0.5),
        "s5_b_im": nrm(25, (ns_, G, P, S), (2.0 * S) ** -0.5),
        "s5_c_re": nrm(26, (ns_, G, S, P), (2.0 * P) ** -0.5),
        "s5_c_im": nrm(27, (ns_, G, S, P), (2.0 * P) ** -0.5),
        "s5_d": nrm(28, (ns_, C), 1.0),
        "s5_w_glu": glu,
        "mlp_w1": nrm(31, (DEPTH, C, D_FF), C ** -0.5),
        "mlp_w2": nrm(32, (DEPTH, D_FF, C), DN_BETA * D_FF ** -0.5),
    }


def reference(x, ln_g, ln_b, rw_mu, rw_w0, rw_w1, rw_w2, rw_a0, rw_a1, rw_a2, rw_g1, rw_g2,
              rw_k_k, rw_k_a, rw_r_k, rw_wr, rw_wk, rw_wv, rw_wo, rw_lnx_g, rw_lnx_b,
              s5_a_re, s5_a_im, s5_log_dt, s5_b_re, s5_b_im, s5_c_re, s5_c_im, s5_d, s5_w_glu,
              mlp_w1, mlp_w2):
    h = x
    for i in range(DEPTH):
        j = i // N_MIXERS
        if i % N_MIXERS == 0:
            mix = rwkv7_time_mix(h, rw_mu[j], rw_w0[j], rw_w1[j], rw_w2[j], rw_a0[j], rw_a1[j],
                                 rw_a2[j], rw_g1[j], rw_g2[j], rw_k_k[j], rw_k_a[j], rw_r_k[j],
                                 rw_wr[j], rw_wk[j], rw_wv[j], rw_wo[j], rw_lnx_g[j], rw_lnx_b[j])
        else:
            mix = s5_mix(h, s5_a_re[j], s5_a_im[j], s5_log_dt[j], s5_b_re[j], s5_b_im[j],
                         s5_c_re[j], s5_c_im[j], s5_d[j], s5_w_glu[j])
        h = layer_norm(DN_ALPHA * h + mix, ln_g[2 * i], ln_b[2 * i])
        h = layer_norm(DN_ALPHA * h + sq_relu_mlp(h, mlp_w1[i], mlp_w2[i]),
                       ln_g[2 * i + 1], ln_b[2 * i + 1])
    return h
```

```cpp
#include <hip/hip_runtime.h>
#include <hip/hip_fp16.h>
#include <cstdio>
#include <cstdint>

namespace v0 {
constexpr int NB = 4, T = 4096, C = 1024, M = NB * T, H = 16, HD = 64, FF = 4096;
constexpr int LW = 64, LA = 64, LG = 160, LTOT = 288;
constexpr int SG = 64, SP = 64, SC = 16;
constexpr float DN_ALPHA = 1.41421356237f;
constexpr float LN_EPS = 1e-5f, GN_EPS = 64e-5f;
constexpr size_t MiB = 1u << 20;

__device__ __forceinline__ float bf16r(float f) { unsigned u = __float_as_uint(f); u = (u + 0x7fffu + ((u >> 16) & 1u)) & 0xffff0000u; return __uint_as_float(u); }
__device__ __forceinline__ unsigned short f2bf(float f) { unsigned u = __float_as_uint(f); return (unsigned short)((u + 0x7fffu + ((u >> 16) & 1u)) >> 16); }
__device__ __forceinline__ float bf2f(unsigned short b) { return __uint_as_float(((unsigned)b) << 16); }
__device__ __forceinline__ float sigmoidf_(float x) { return 1.0f / (1.0f + __expf(-x)); }

struct ALMix { const float* x; const float* mu;
    __device__ __forceinline__ float operator()(int m, int k) const { const float xc = x[(size_t)m * C + k]; const float xp = (m % T == 0) ? 0.f : x[(size_t)(m - 1) * C + k]; return bf16r(xc + (xp - xc) * mu[k]); } };
struct ALF32 { const float* a; int lda; int pad;
    __device__ __forceinline__ float operator()(int m, int k) const { return bf16r(a[(size_t)m * lda + k]); } };
struct ALBf { const unsigned short* a; int lda; int pad;
    __device__ __forceinline__ float operator()(int m, int k) const { return bf2f(a[(size_t)m * lda + k]); } };
struct EPF32 { float* c; int ldc; int pad; __device__ __forceinline__ void operator()(int m, int n, float v) const { c[(size_t)m * ldc + n] = v; } };
struct EPHalf { __half* c; int ldc; int pad; __device__ __forceinline__ void operator()(int m, int n, float v) const { c[(size_t)m * ldc + n] = __float2half(v); } };
struct EPLora1 { float* c; int ldc; int col0; int act; int pad;
    __device__ __forceinline__ void operator()(int m, int n, float v) const { float r = v; if (act == 1) r = tanhf(v); else if (act == 2) r = sigmoidf_(v); c[(size_t)m * ldc + col0 + n] = r; } };
struct EPRelu2Bf { unsigned short* c; int ldc; int pad; __device__ __forceinline__ void operator()(int m, int n, float v) const { const float r = v > 0.f ? v : 0.f; c[(size_t)m * ldc + n] = f2bf(r * r); } };

template <class AL, class EP>
__global__ void __launch_bounds__(256) gemm_naive(AL al, const float* __restrict__ B, int ldb, int N, int K, int pad_, EP ep) {
    __shared__ float As[16][64 + 4];
    __shared__ float Bs[16][64 + 4];
    const int tid = threadIdx.x, tx = tid & 15, ty = tid >> 4;
    const int m0 = blockIdx.y * 64, n0 = blockIdx.x * 64;
    float acc[4][4];
#pragma unroll
    for (int i = 0; i < 4; ++i)
#pragma unroll
        for (int j = 0; j < 4; ++j) acc[i][j] = 0.f;
    for (int k0 = 0; k0 < K; k0 += 16) {
#pragma unroll
        for (int i = 0; i < 4; ++i) { const int idx = tid + i * 256; const int row = idx >> 4, kk = idx & 15; As[kk][row] = al(m0 + row, k0 + kk); }
#pragma unroll
        for (int i = 0; i < 4; ++i) { const int idx = tid + i * 256; const int kk = idx >> 6, col = idx & 63; Bs[kk][col] = (n0 + col < N) ? bf16r(B[(size_t)(k0 + kk) * ldb + n0 + col]) : 0.f; }
        __syncthreads();
#pragma unroll
        for (int kk = 0; kk < 16; ++kk) {
            float a[4], b[4];
#pragma unroll
            for (int i = 0; i < 4; ++i) { a[i] = As[kk][ty * 4 + i]; b[i] = Bs[kk][tx * 4 + i]; }
#pragma unroll
            for (int i = 0; i < 4; ++i)
#pragma unroll
                for (int j = 0; j < 4; ++j) acc[i][j] = fmaf(a[i], b[j], acc[i][j]);
        }
        __syncthreads();
    }
#pragma unroll
    for (int i = 0; i < 4; ++i)
#pragma unroll
        for (int j = 0; j < 4; ++j) { const int n = n0 + tx * 4 + j; if (n < N) ep(m0 + ty * 4 + i, n, acc[i][j]); }
}

__global__ void __launch_bounds__(256) k_lora2(const float* __restrict__ L, const float* __restrict__ w0, const float* __restrict__ w2, const float* __restrict__ a0, const float* __restrict__ a2,
                                               const float* __restrict__ g2, const float* __restrict__ k_k, const float* __restrict__ k_a, const float* __restrict__ r_k,
                                               const __half* __restrict__ R, __half* __restrict__ Kp  , __half* __restrict__ OMW, __half* __restrict__ KK, __half* __restrict__ BB,
                                               __half* __restrict__ G, float* __restrict__ bonus) {
    __shared__ float Ls[LTOT];
    const int t = blockIdx.x, tid = threadIdx.x;
    for (int i = tid; i < LTOT; i += 256) Ls[i] = bf16r(L[(size_t)t * LTOT + i]);
    __syncthreads();
    float kkraw[4], kp[4], asg[4]; float ss = 0.f, bs = 0.f;
    float wacc[4] = {0.f, 0.f, 0.f, 0.f}, aacc[4] = {0.f, 0.f, 0.f, 0.f}, gacc[4] = {0.f, 0.f, 0.f, 0.f};
#pragma unroll 4
    for (int j = 0; j < LW; ++j) { const float4 w = *(const float4*)(w2 + (size_t)j * C + tid * 4); const float l = Ls[j];
        wacc[0] = fmaf(l, bf16r(w.x), wacc[0]); wacc[1] = fmaf(l, bf16r(w.y), wacc[1]); wacc[2] = fmaf(l, bf16r(w.z), wacc[2]); wacc[3] = fmaf(l, bf16r(w.w), wacc[3]); }
#pragma unroll 4
    for (int j = 0; j < LA; ++j) { const float4 w = *(const float4*)(a2 + (size_t)j * C + tid * 4); const float l = Ls[LW + j];
        aacc[0] = fmaf(l, bf16r(w.x), aacc[0]); aacc[1] = fmaf(l, bf16r(w.y), aacc[1]); aacc[2] = fmaf(l, bf16r(w.z), aacc[2]); aacc[3] = fmaf(l, bf16r(w.w), aacc[3]); }
#pragma unroll 4
    for (int j = 0; j < LG; ++j) { const float4 w = *(const float4*)(g2 + (size_t)j * C + tid * 4); const float l = Ls[LW + LA + j];
        gacc[0] = fmaf(l, bf16r(w.x), gacc[0]); gacc[1] = fmaf(l, bf16r(w.y), gacc[1]); gacc[2] = fmaf(l, bf16r(w.z), gacc[2]); gacc[3] = fmaf(l, bf16r(w.w), gacc[3]); }
#pragma unroll
    for (int q = 0; q < 4; ++q) {
        const int c = tid * 4 + q;
        const float wpre = w0[c] + wacc[q];
        const float decay = __expf(-0.60653065971f * sigmoidf_(wpre));
        const float as = sigmoidf_(a0[c] + aacc[q]);
        const size_t o = (size_t)t * C + c;
        OMW[o] = __float2half(1.0f - decay);
        G[o] = __float2half(gacc[q]);
        const float k = __half2float(Kp[o]), r = __half2float(R[o]);
        kkraw[q] = k * k_k[c]; ss += kkraw[q] * kkraw[q];
        kp[q] = k * (1.0f + (as - 1.0f) * k_a[c]);
        asg[q] = as;
        bs += r * kp[q] * r_k[c];
    }
#pragma unroll
    for (int o = 1; o < 16; o <<= 1) { ss += __shfl_xor(ss, o); bs += __shfl_xor(bs, o); }
    const float inv = 1.0f / fmaxf(sqrtf(ss), 1e-12f);
#pragma unroll
    for (int q = 0; q < 4; ++q) {
        const size_t o = (size_t)t * C + tid * 4 + q;
        const float kk = kkraw[q] * inv;
        KK[o] = __float2half(kk); BB[o] = __float2half(kk * asg[q]); Kp[o] = __float2half(kp[q]);
    }
    if ((tid & 15) == 0) bonus[(size_t)t * H + (tid >> 4)] = bs;
}

__global__ void __launch_bounds__(64) k_scan(const __half* __restrict__ R, const __half* __restrict__ OMW, const __half* __restrict__ Kp, const __half* __restrict__ V,
                                             const __half* __restrict__ KK, const __half* __restrict__ BB, float* __restrict__ O) {
    __shared__ float sa_[64], sb_[64], sk_[64], sr_[64], sw_[64];
    const int b = blockIdx.x / H, h = blockIdx.x % H, i = threadIdx.x;
    float S[64];
#pragma unroll
    for (int k = 0; k < 64; ++k) S[k] = 0.f;
    for (int t = 0; t < T; ++t) {
        const size_t o = ((size_t)(b * T + t)) * C + h * HD + i;
        sa_[i] = -__half2float(KK[o]); sb_[i] = __half2float(BB[o]); sk_[i] = __half2float(Kp[o]); sr_[i] = __half2float(R[o]); sw_[i] = 1.0f - __half2float(OMW[o]);
        const float v = __half2float(V[o]);
        __syncthreads();
        float sa = 0.f;
#pragma unroll
        for (int k = 0; k < 64; ++k) sa = fmaf(S[k], sa_[k], sa);
        float ov = 0.f;
#pragma unroll
        for (int k = 0; k < 64; ++k) { S[k] = fmaf(S[k], sw_[k], fmaf(sa, sb_[k], v * sk_[k])); ov = fmaf(S[k], sr_[k], ov); }
        O[o] = ov;
        __syncthreads();
    }
}

__global__ void __launch_bounds__(256) k_gn(const float* __restrict__ O, const __half* __restrict__ G, const __half* __restrict__ V, const float* __restrict__ bonus,
                                            const float* __restrict__ lnx_g, const float* __restrict__ lnx_b, float* __restrict__ Aw) {
    const int t = blockIdx.x, tid = threadIdx.x;
    float o[4]; float s = 0.f;
#pragma unroll
    for (int q = 0; q < 4; ++q) { o[q] = O[(size_t)t * C + tid * 4 + q]; s += o[q]; }
#pragma unroll
    for (int d = 1; d < 16; d <<= 1) s += __shfl_xor(s, d);
    const float mean = s * (1.f / 64.f); float q2 = 0.f;
#pragma unroll
    for (int q = 0; q < 4; ++q) { const float dd = o[q] - mean; q2 += dd * dd; }
#pragma unroll
    for (int d = 1; d < 16; d <<= 1) q2 += __shfl_xor(q2, d);
    const float rstd = rsqrtf(q2 * (1.f / 64.f) + GN_EPS);
    const float bn = bonus[(size_t)t * H + (tid >> 4)];
#pragma unroll
    for (int q = 0; q < 4; ++q) { const int c = tid * 4 + q; const size_t idx = (size_t)t * C + c;
        const float val = (o[q] - mean) * rstd * lnx_g[c] + lnx_b[c] + bn * __half2float(V[idx]);
        Aw[idx] = val * __half2float(G[idx]); }
}

__device__ __forceinline__ float block_sum256(float v, float* red) {
#pragma unroll
    for (int d = 1; d < 64; d <<= 1) v += __shfl_xor(v, d);
    __syncthreads();
    if ((threadIdx.x & 63) == 0) red[threadIdx.x >> 6] = v;
    __syncthreads();
    return red[0] + red[1] + red[2] + red[3];
}
__global__ void __launch_bounds__(256) k_ln(const float* base, const float* X, int ldx, int mode, const float* __restrict__ g, const float* __restrict__ bta, float* out) {
    __shared__ float red[4];
    const int t = blockIdx.x, tid = threadIdx.x;
    float v[4]; float s = 0.f;
#pragma unroll
    for (int q = 0; q < 4; ++q) { const int c = tid * 4 + q; float a = X[(size_t)t * ldx + c]; if (mode == 1) a = a * sigmoidf_(X[(size_t)t * ldx + C + c]);
        v[q] = DN_ALPHA * base[(size_t)t * C + c] + a; s += v[q]; }
    const float mean = block_sum256(s, red) * (1.f / C); float q2 = 0.f;
#pragma unroll
    for (int q = 0; q < 4; ++q) { const float d = v[q] - mean; q2 += d * d; }
    const float rstd = rsqrtf(block_sum256(q2, red) * (1.f / C) + LN_EPS);
#pragma unroll
    for (int q = 0; q < 4; ++q) { const int c = tid * 4 + q; out[(size_t)t * C + c] = (v[q] - mean) * rstd * g[c] + bta[c]; }
}

__global__ void __launch_bounds__(64) k_s5(const float* __restrict__ Hin, const float* __restrict__ a_re, const float* __restrict__ a_im, const float* __restrict__ log_dt,
                                           const float* __restrict__ b_re, const float* __restrict__ b_im, const float* __restrict__ c_re, const float* __restrict__ c_im,
                                           const float* __restrict__ dsk, float* __restrict__ Y) {
    const int b = blockIdx.x / SG, g = blockIdx.x % SG, p = threadIdx.x;
    const double dt = exp((double)log_dt[g]);
    const double lre = fmin((double)a_re[g * SP + p], -1e-4), lim = (double)a_im[g * SP + p];
    const double mag = exp(dt * lre), abr = mag * cos(dt * lim), abi = mag * sin(dt * lim);
    const double den = lre * lre + lim * lim, nr = abr - 1.0, ni = abi;
    const double cre = (nr * lre + ni * lim) / den, cim = (ni * lre - nr * lim) / den;
    float bbr[SC], bbi[SC], ccr[SC], cci[SC];
#pragma unroll
    for (int c = 0; c < SC; ++c) {
        const double br = b_re[((size_t)g * SP + p) * SC + c], bi = b_im[((size_t)g * SP + p) * SC + c];
        bbr[c] = (float)(cre * br - cim * bi); bbi[c] = (float)(cre * bi + cim * br);
        ccr[c] = c_re[((size_t)g * SC + c) * SP + p]; cci[c] = c_im[((size_t)g * SC + c) * SP + p];
    }
    const float ar = (float)abr, ai = (float)abi;
    float sr = 0.f, si = 0.f;
    const float dl = (p < SC) ? dsk[g * SC + p] : 0.f;
    for (int t = 0; t < T; ++t) {
        const float* urow = Hin + ((size_t)(b * T + t)) * C + g * SC;
        float u[SC];
#pragma unroll
        for (int c = 0; c < SC; ++c) u[c] = urow[c];
        float bur = 0.f, bui = 0.f;
#pragma unroll
        for (int c = 0; c < SC; ++c) { bur = fmaf(u[c], bbr[c], bur); bui = fmaf(u[c], bbi[c], bui); }
        const float nsr = ar * sr - ai * si + bur, nsi = ar * si + ai * sr + bui; sr = nsr; si = nsi;
        float yout = 0.f;
#pragma unroll
        for (int c = 0; c < SC; ++c) {
            float y = sr * ccr[c] - si * cci[c];
#pragma unroll
            for (int d = 1; d < 64; d <<= 1) y += __shfl_xor(y, d);
            if (p == c) yout = y;
        }
        if (p < SC) {
            const float up = urow[p];
            const float yy = yout + up * dl;
            const float gl = 0.5f * yy * (1.0f + tanhf(0.7978845608f * (yy + 0.044715f * yy * yy * yy)));
            Y[((size_t)(b * T + t)) * C + g * SC + p] = gl;
        }
    }
}
}

extern "C" void kernel_launch(void* const* d_in, const int* in_sizes, int n_in, void* d_out, int out_size, void* d_ws, size_t ws_size, hipStream_t stream) {
    using namespace v0;
    const float* x = (const float*)d_in[0]; const float* ln_g = (const float*)d_in[1]; const float* ln_b = (const float*)d_in[2];
    const float* rw_mu = (const float*)d_in[3]; const float* rw_w0 = (const float*)d_in[4]; const float* rw_w1 = (const float*)d_in[5]; const float* rw_w2 = (const float*)d_in[6];
    const float* rw_a0 = (const float*)d_in[7]; const float* rw_a1 = (const float*)d_in[8]; const float* rw_a2 = (const float*)d_in[9]; const float* rw_g1 = (const float*)d_in[10];
    const float* rw_g2 = (const float*)d_in[11]; const float* rw_k_k = (const float*)d_in[12]; const float* rw_k_a = (const float*)d_in[13]; const float* rw_r_k = (const float*)d_in[14];
    const float* rw_wr = (const float*)d_in[15]; const float* rw_wk = (const float*)d_in[16]; const float* rw_wv = (const float*)d_in[17]; const float* rw_wo = (const float*)d_in[18];
    const float* rw_lnx_g = (const float*)d_in[19]; const float* rw_lnx_b = (const float*)d_in[20];
    const float* s5_a_re = (const float*)d_in[21]; const float* s5_a_im = (const float*)d_in[22]; const float* s5_log_dt = (const float*)d_in[23];
    const float* s5_b_re = (const float*)d_in[24]; const float* s5_b_im = (const float*)d_in[25]; const float* s5_c_re = (const float*)d_in[26]; const float* s5_c_im = (const float*)d_in[27];
    const float* s5_d = (const float*)d_in[28]; const float* s5_w_glu = (const float*)d_in[29]; const float* mlp_w1 = (const float*)d_in[30]; const float* mlp_w2 = (const float*)d_in[31];
    unsigned char* ws = (unsigned char*)d_ws; float* OUT = (float*)d_out;
    float* L = (float*)(ws + 0 * MiB);
    __half* R = (__half*)(ws + 20 * MiB); __half* K = (__half*)(ws + 52 * MiB); __half* V = (__half*)(ws + 84 * MiB);
    __half* OMW = (__half*)(ws + 116 * MiB); __half* KK = (__half*)(ws + 148 * MiB); __half* BB = (__half*)(ws + 180 * MiB); __half* G = (__half*)(ws + 212 * MiB);
    float* bonus = (float*)(ws + 244 * MiB);
    float* Aw = (float*)(ws + 116 * MiB); float* tmp1 = (float*)(ws + 20 * MiB); float* h = (float*)(ws + 180 * MiB);
    unsigned short* act = (unsigned short*)(ws + 20 * MiB); float* Z = (float*)(ws + 20 * MiB);
    const dim3 blk(256);
    gemm_naive<<<dim3(1, M / 64), blk, 0, stream>>>(ALMix{x, rw_mu + 1 * C}, rw_w1, LW, LW, C, 0, EPLora1{L, LTOT, 0, 1});
    gemm_naive<<<dim3(1, M / 64), blk, 0, stream>>>(ALMix{x, rw_mu + 4 * C}, rw_a1, LA, LA, C, 0, EPLora1{L, LTOT, LW, 0});
    gemm_naive<<<dim3(3, M / 64), blk, 0, stream>>>(ALMix{x, rw_mu + 5 * C}, rw_g1, LG, LG, C, 0, EPLora1{L, LTOT, LW + LA, 2});
    gemm_naive<<<dim3(C / 64, M / 64), blk, 0, stream>>>(ALMix{x, rw_mu + 0 * C}, rw_wr, C, C, C, 0, EPHalf{R, C});
    gemm_naive<<<dim3(C / 64, M / 64), blk, 0, stream>>>(ALMix{x, rw_mu + 2 * C}, rw_wk, C, C, C, 0, EPHalf{K, C});
    gemm_naive<<<dim3(C / 64, M / 64), blk, 0, stream>>>(ALMix{x, rw_mu + 3 * C}, rw_wv, C, C, C, 0, EPHalf{V, C});
    k_lora2<<<M, 256, 0, stream>>>(L, rw_w0, rw_w2, rw_a0, rw_a2, rw_g2, rw_k_k, rw_k_a, rw_r_k, R, K, OMW, KK, BB, G, bonus);
    k_scan<<<NB * H, 64, 0, stream>>>(R, OMW, K, V, KK, BB, OUT);
    k_gn<<<M, 256, 0, stream>>>(OUT, G, V, bonus, rw_lnx_g, rw_lnx_b, Aw);
    gemm_naive<<<dim3(C / 64, M / 64), blk, 0, stream>>>(ALF32{Aw, C}, rw_wo, C, C, C, 0, EPF32{tmp1, C});
    k_ln<<<M, 256, 0, stream>>>(x, tmp1, C, 0, ln_g + 0 * C, ln_b + 0 * C, h);
    gemm_naive<<<dim3(FF / 64, M / 64), blk, 0, stream>>>(ALF32{h, C}, mlp_w1, FF, FF, C, 0, EPRelu2Bf{act, FF});
    gemm_naive<<<dim3(C / 64, M / 64), blk, 0, stream>>>(ALBf{act, FF}, mlp_w2, C, C, FF, 0, EPF32{OUT, C});
    k_ln<<<M, 256, 0, stream>>>(h, OUT, C, 0, ln_g + 1 * C, ln_b + 1 * C, h);
    k_s5<<<NB * SG, 64, 0, stream>>>(h, s5_a_re, s5_a_im, s5_log_dt, s5_b_re, s5_b_im, s5_c_re, s5_c_im, s5_d, OUT);
    gemm_naive<<<dim3(2 * C / 64, M / 64), blk, 0, stream>>>(ALF32{OUT, C}, s5_w_glu, 2 * C, 2 * C, C, 0, EPF32{Z, 2 * C});
    k_ln<<<M, 256, 0, stream>>>(h, Z, 2 * C, 1, ln_g + 2 * C, ln_b + 2 * C, h);
    gemm_naive<<<dim3(FF / 64, M / 64), blk, 0, stream>>>(ALF32{h, C}, mlp_w1 + (size_t)C * FF, FF, FF, C, 0, EPRelu2Bf{act, FF});
    gemm_naive<<<dim3(C / 64, M / 64), blk, 0, stream>>>(ALBf{act, FF}, mlp_w2 + (size_t)FF * C, C, C, FF, 0, EPF32{OUT, C});
    k_ln<<<M, 256, 0, stream>>>(h, OUT, C, 0, ln_g + 3 * C, ln_b + 3 * C, OUT);
}
```
